# Optimizing an MI355X kernel written in HIP

```python
import jax, jax.numpy as jnp
from jax import lax
import numpy as np

D_MODEL = 1024
BATCH = 2
SEQ = 8192
DEPTH = 1

GRID_W = 64
CTX_LEN = 256
CHUNK = 128
MIX_WIDTH = D_MODEL
A_WIDTH = MIX_WIDTH // 2
A_GROUPS = 4
A_GROUP_DIM = A_WIDTH // A_GROUPS
R_WIDTH = MIX_WIDTH - A_WIDTH
R_HEADS = 4
R_HEAD_DIM = R_WIDTH // R_HEADS
IN_COLS = 2 * A_WIDTH + 5 * R_WIDTH
D_FF = -(-8 * D_MODEL // (3 * 256)) * 256
RMS_EPS = 1e-6
ROPE_BASE = 10000.0

kernel_name = "hymba_gmlp_retention_prefix_dit_block"


def rmsnorm(x, g):
    x32 = x.astype(jnp.float32)
    y = x32 * lax.rsqrt(jnp.mean(x32 * x32, axis=-1, keepdims=True) + RMS_EPS)
    return (y * g.astype(jnp.float32)).astype(x.dtype)


def head_norm(o):
    return o * lax.rsqrt(jnp.mean(o * o, axis=-1, keepdims=True) + RMS_EPS)


def modulate(h, shift, scale):
    return h * (1.0 + scale[:, None, :]) + shift[:, None, :]


def rope_2d(t, rows, cols):
    half = t.shape[-1] // 2
    n_freq = half // 2
    inv = ROPE_BASE ** (-jnp.arange(n_freq, dtype=jnp.float32) / n_freq)

    def rot(u, pos):
        ang = pos[:, None] * inv[None, :]
        cos = jnp.cos(ang)[None, :, None, :]
        sin = jnp.sin(ang)[None, :, None, :]
        u1, u2 = u[..., :n_freq], u[..., n_freq:]
        return jnp.concatenate([u1 * cos - u2 * sin, u1 * sin + u2 * cos], axis=-1)

    return jnp.concatenate([rot(t[..., :half], rows), rot(t[..., half:], cols)], axis=-1)


def chunk_states(k, v, log_gamma, s0):
    B, L, H, dk = k.shape
    n = L // CHUNK
    kc = k.reshape(B, n, CHUNK, H, dk)
    vc = v.reshape(B, n, CHUNK, H, v.shape[-1])
    pos = jnp.arange(CHUNK, dtype=jnp.float32)
    zeta = jnp.exp(log_gamma[:, None] * (CHUNK - 1 - pos)[None, :])
    upd = jnp.einsum('bnjhd,hj,bnjhe->nbhde', kc, zeta, vc)
    decay = jnp.exp(log_gamma * CHUNK)[None, :, None, None]

    def step(s, u):
        return decay * s + u, s

    s_final, s_prev = lax.scan(step, s0, upd)
    return s_prev, s_final


def retention_out(q, k, v, log_gamma, s_prev):
    B, L, H, dk = q.shape
    n = L // CHUNK
    qc = q.reshape(B, n, CHUNK, H, dk)
    kc = k.reshape(B, n, CHUNK, H, dk)
    vc = v.reshape(B, n, CHUNK, H, v.shape[-1])
    pos = jnp.arange(CHUNK, dtype=jnp.float32)
    diff = pos[:, None] - pos[None, :]
    dmask = jnp.where(diff[None] >= 0,
                      jnp.exp(log_gamma[:, None, None] * jnp.maximum(diff, 0.0)[None]), 0.0)
    scores = jnp.einsum('bnihd,bnjhd->bnhij', qc, kc) * dmask[None, None]
    inner = jnp.einsum('bnhij,bnjhe->bnihe', scores, vc)
    xi = jnp.exp(log_gamma[:, None] * (pos + 1.0)[None, :])
    cross = jnp.einsum('bnihd,hi,nbhde->bnihe', qc, xi, s_prev)
    return (inner + cross).reshape(B, L, H, v.shape[-1])


def spatial_gating(zu, zv, sg_gain, sg_w, sg_b):
    B, L, _ = zu.shape
    n = L // CHUNK
    u = jax.nn.gelu(zu)
    v = jax.nn.gelu(zv).reshape(B, n, CHUNK, A_GROUPS, A_GROUP_DIM)
    v32 = v.astype(jnp.float32)
    v = (v32 * lax.rsqrt(jnp.mean(v32 * v32, axis=-1, keepdims=True) + RMS_EPS)
         * sg_gain.reshape(A_GROUPS, A_GROUP_DIM)).astype(zu.dtype)
    mixed = jnp.einsum('gpq,bnqgc->bnpgc', sg_w, v) + jnp.transpose(sg_b)[None, None, :, :, None]
    return u * mixed.reshape(B, L, A_WIDTH)


def split_proj(z):
    cuts = [A_WIDTH, 2 * A_WIDTH] + [2 * A_WIDTH + i * R_WIDTH for i in range(1, 5)]
    return jnp.split(z, cuts, axis=-1)


def heads(t):
    B, L, _ = t.shape
    return t.astype(jnp.float32).reshape(B, L, R_HEADS, R_HEAD_DIM)


def ffn(h, w_gate, w_up, w_down):
    return (jax.nn.silu(h @ w_gate) * (h @ w_up)) @ w_down


def setup_inputs(seed: int = 0) -> dict:
    key = jax.random.key(seed)
    ks = jax.random.split(key, 24)
    f32 = jnp.float32
    nrm = lambda k, s: jax.random.normal(k, s, dtype=f32)
    gamma0 = 1.0 - 2.0 ** (-5.0 - np.arange(R_HEADS, dtype=np.float32))
    logit0 = jnp.asarray(np.log(gamma0) - np.log1p(-gamma0), dtype=f32)
    return {
        "x": nrm(ks[0], (BATCH, SEQ, D_MODEL)),
        "c": nrm(ks[1], (BATCH, D_MODEL)),
        "ctx": nrm(ks[2], (BATCH, CTX_LEN, D_MODEL)),
        "c_ctx": nrm(ks[3], (D_MODEL,)),
        "w_mod": nrm(ks[4], (DEPTH, D_MODEL, 6 * D_MODEL)) * (0.5 * D_MODEL ** -0.5),
        "b_mod": nrm(ks[5], (DEPTH, 6 * D_MODEL)) * 0.02,
        "norm1": 1.0 + 0.02 * nrm(ks[6], (DEPTH, D_MODEL)),
        "w_in": nrm(ks[7], (DEPTH, D_MODEL, IN_COLS)) * D_MODEL ** -0.5,
        "sg_gain": 1.0 + 0.02 * nrm(ks[8], (DEPTH, A_WIDTH)),
        "sg_w": nrm(ks[9], (DEPTH, A_GROUPS, CHUNK, CHUNK)) * CHUNK ** -0.5,
        "sg_b": 1.0 + 0.02 * nrm(ks[10], (DEPTH, A_GROUPS, CHUNK)),
        "ret_logit_f": logit0[None, :] + 0.05 * nrm(ks[11], (DEPTH, R_HEADS)),
        "ret_logit_b": logit0[None, :] + 0.05 * nrm(ks[12], (DEPTH, R_HEADS)),
        "w_out": nrm(ks[13], (DEPTH, MIX_WIDTH, D_MODEL)) * MIX_WIDTH ** -0.5,
        "norm2": 1.0 + 0.02 * nrm(ks[14], (DEPTH, D_MODEL)),
        "w_gate": nrm(ks[15], (DEPTH, D_MODEL, D_FF)) * D_MODEL ** -0.5,
        "w_up": nrm(ks[16], (DEPTH, D_MODEL, D_FF)) * D_MODEL ** -0.5,
        "w_down": nrm(ks[17], (DEPTH, D_FF, D_MODEL)) * D_FF ** -0.5,
        "norm_f": 1.0 + 0.02 * nrm(ks[18], (D_MODEL,)),
    }


def reference(x, c, ctx, c_ctx, w_mod, b_mod, norm1, w_in, sg_gain, sg_w, sg_b,
              ret_logit_f, ret_logit_b, w_out, norm2, w_gate, w_up, w_down, norm_f):
    B, L, _ = x.shape
    rows_n = L // GRID_W
    rows = jnp.repeat(jnp.arange(rows_n, dtype=jnp.float32), GRID_W)
    cols = jnp.tile(jnp.arange(GRID_W, dtype=jnp.float32), rows_n)
    s_zero = jnp.zeros((B, R_HEADS, R_HEAD_DIM, R_HEAD_DIM), jnp.float32)
    k_scale = R_HEAD_DIM ** -0.5
    kv_lo = 2 * A_WIDTH + R_WIDTH
    kv_hi = 2 * A_WIDTH + 3 * R_WIDTH

    for l in range(DEPTH):
        last = l == DEPTH - 1
        sh1, sc1, g1, sh2, sc2, g2 = jnp.split(jax.nn.silu(c) @ w_mod[l] + b_mod[l], 6, axis=-1)
        csh1, csc1, cg1, csh2, csc2, cg2 = jnp.split(
            (jax.nn.silu(c_ctx) @ w_mod[l] + b_mod[l])[None, :], 6, axis=-1)
        lg_f = jax.nn.log_sigmoid(ret_logit_f[l].astype(jnp.float32))
        lg_b = jax.nn.log_sigmoid(ret_logit_b[l].astype(jnp.float32))

        hc = modulate(rmsnorm(ctx, norm1[l]), csh1, csc1)
        if last:
            kc_r, vc_r = jnp.split(hc @ w_in[l][:, kv_lo:kv_hi], 2, axis=-1)
        else:
            cu, cv, cq_r, kc_r, vc_r, cgf, cgb = split_proj(hc @ w_in[l])
        kc = heads(kc_r) * k_scale
        vc = heads(vc_r)
        kc_rev, vc_rev = jnp.flip(kc, 1), jnp.flip(vc, 1)
        sp_cf, s_cf = chunk_states(kc, vc, lg_f, s_zero)
        sp_cb, s_cb = chunk_states(kc_rev, vc_rev, lg_b, s_zero)
        if not last:
            qc = heads(cq_r)
            o_cf = retention_out(qc, kc, vc, lg_f, sp_cf)
            o_cb = jnp.flip(retention_out(jnp.flip(qc, 1), kc_rev, vc_rev, lg_b, sp_cb), 1)
            Lc = ctx.shape[1]
            yc_r = (jax.nn.silu(cgf.astype(jnp.float32)) * head_norm(o_cf).reshape(B, Lc, R_WIDTH)
                    + jax.nn.silu(cgb.astype(jnp.float32)) * head_norm(o_cb).reshape(B, Lc, R_WIDTH))
            yc_a = spatial_gating(cu, cv, sg_gain[l], sg_w[l], sg_b[l])
            yc = jnp.concatenate([yc_a, yc_r.astype(ctx.dtype)], axis=-1) @ w_out[l]
            ctx_new = ctx + cg1[:, None, :] * yc
            hc2 = modulate(rmsnorm(ctx_new, norm2[l]), csh2, csc2)
            ctx_next = ctx_new + cg2[:, None, :] * ffn(hc2, w_gate[l], w_up[l], w_down[l])

        hx = modulate(rmsnorm(x, norm1[l]), sh1, sc1)
        u, v, q_r, k_r, v_r, gf, gb = split_proj(hx @ w_in[l])
        y_a = spatial_gating(u, v, sg_gain[l], sg_w[l], sg_b[l])
        q = rope_2d(heads(q_r), rows, cols)
        k = rope_2d(heads(k_r), rows, cols) * k_scale
        vv = heads(v_r)
        sp_f, _ = chunk_states(k, vv, lg_f, s_cf)
        o_f = retention_out(q, k, vv, lg_f, sp_f)
        q_rev, k_rev, v_rev = jnp.flip(q, 1), jnp.flip(k, 1), jnp.flip(vv, 1)
        sp_b, _ = chunk_states(k_rev, v_rev, lg_b, s_cb)
        o_b = jnp.flip(retention_out(q_rev, k_rev, v_rev, lg_b, sp_b), 1)
        y_r = (jax.nn.silu(gf.astype(jnp.float32)) * head_norm(o_f).reshape(B, L, R_WIDTH)
               + jax.nn.silu(gb.astype(jnp.float32)) * head_norm(o_b).reshape(B, L, R_WIDTH))
        y = jnp.concatenate([y_a, y_r.astype(x.dtype)], axis=-1) @ w_out[l]
        x = x + g1[:, None, :] * y
        h2 = modulate(rmsnorm(x, norm2[l]), sh2, sc2)
        x = x + g2[:, None, :] * ffn(h2, w_gate[l], w_up[l], w_down[l])
        if not last:
            ctx = ctx_next

    return rmsnorm(x, norm_f)
```

```cpp
#include <hip/hip_runtime.h>
#include <cstdio>
#include <cstdint>
namespace pg8 {
#define PG8_LAS __attribute__((address_space(3)))
typedef unsigned short bf16_t;
typedef short bf16x8 __attribute__((ext_vector_type(8)));
typedef float f32x4 __attribute__((ext_vector_type(4)));
typedef unsigned u32x4 __attribute__((ext_vector_type(4)));
constexpr int BM = 256, BK = 64, HALF = 128, HTB = HALF * BK * 2  , STAGE_BYTES = 8 * HTB, NXCD = 8, WGM = 8;

__host__ __device__ __forceinline__ int lds_byte(int r, int c) { const int st = (r >> 4) * 2 + (c >> 5), rr = r & 15, cc = c & 31, ob = rr * 64 + cc * 2; return st * 1024 + (ob ^ (((ob >> 9) & 1) << 5)); }
__host__ __device__ __forceinline__ void stage_rc(int b, int& R, int& C) { const int st = b / 1024, sb = b % 1024, swz = sb ^ (((sb >> 9) & 1) << 5); R = (st >> 1) * 16 + swz / 64; C = (st & 1) * 32 + (swz % 64) / 2; }
__host__ __device__ __forceinline__ int perm32(int rho) { const int n = rho >> 4, i = rho & 15; return 8 * (i >> 2) + 4 * n + (i & 3); }

struct Unit { int pm, pn; };
struct Gemm { const bf16_t* A; const bf16_t* Bt; int M, N, K; };

struct StaticOrder {
    int nM, nN, nwg, G, c;
    __host__ __device__ void init(int M, int N, int G_, int c_) { nM = M / BM; nN = N / BM; nwg = nM * nN; G = G_; c = c_; }
    __host__ __device__ bool next(int i, Unit& u) const {
        const long L = (long)i * G + c; if (L >= nwg) return false;
        int wgid = (int)L; { const int q = nwg / NXCD, r = nwg % NXCD, xcd = wgid % NXCD, off = wgid / NXCD; wgid = (xcd < r ? xcd * (q + 1) : r * (q + 1) + (xcd - r) * q) + off; }
        const int nig = WGM * nN, gid = wgid / nig, fm = gid * WGM, gsz = (nM - fm) < WGM ? (nM - fm) : WGM;
        u.pm = fm + ((wgid % nig) % gsz); u.pn = (wgid % nig) / gsz; return true;
    }
    __device__ __forceinline__ void a_ready(const Unit&) const {}
    __device__ __forceinline__ void done(const Unit&) const {}
};

__device__ __forceinline__ unsigned cvt_pk_bf16(float lo, float hi) { unsigned r; asm volatile("v_cvt_pk_bf16_f32 %0, %1, %2" : "=v"(r) : "v"(lo), "v"(hi)); return r; }
template <class Epi, class Sched, bool ALIGN_EPI = false, bool SP2 = false>
__device__ __forceinline__ void gemm_phase(PG8_LAS unsigned char* lds, const Gemm g, const Sched& S, const Epi& E) {
    const int tid = threadIdx.x, wid = __builtin_amdgcn_readfirstlane(tid >> 6), lane = tid & 63, wr = wid >> 2, wc = wid & 3, fr = lane & 15, fq = lane >> 4;
    const int K = g.K, nt = K / BK;
    unsigned voffA[2], voffB[2];
#pragma unroll
    for (int i = 0; i < 2; ++i) { int R, C; stage_rc(tid * 16 + i * 8192, R, C); const int Rb = Epi::PERM ? ((R & ~31) + perm32(R & 31)) : R;
        voffA[i] = (unsigned)(R * K + C) * 2u; voffB[i] = (unsigned)(Rb * K + C) * 2u; }
    const size_t kstep = (size_t)(BK * 2);
    const size_t hstep = (size_t)HALF * K * 2;
    const size_t tstep = 2 * hstep;
    const unsigned ldsw = (unsigned)wid * 1024u;
    const int aoff = lds_byte(wr * 64 + fr, fq * 8), boff = lds_byte(wc * 32 + fr, fq * 8);
#define PG8_SA(b, h) (((b) * 2 + (h)) * HTB)
#define PG8_SB(b, h) ((4 + (b) * 2 + (h)) * HTB)
#define PG8_STAGE(bufoff, gbase, voff) do { _Pragma("unroll") for (int _i = 0; _i < 2; ++_i) \
        __builtin_amdgcn_global_load_lds((const unsigned*)((const char*)(gbase) + (voff)[_i]), (PG8_LAS unsigned*)(lds + (bufoff) + ldsw + _i * 8192), 16, 0, 0); } while (0)
#define PG8_LDA(dst, b, h) do { _Pragma("unroll") for (int m = 0; m < 4; ++m) _Pragma("unroll") for (int k = 0; k < 2; ++k) dst[m][k] = *(const PG8_LAS bf16x8*)(lds + PG8_SA(b, h) + aoff + m * 2048 + k * 1024); } while (0)
#define PG8_LDB(dst, b, h) do { _Pragma("unroll") for (int n = 0; n < 2; ++n) _Pragma("unroll") for (int k = 0; k < 2; ++k) dst[n][k] = *(const PG8_LAS bf16x8*)(lds + PG8_SB(b, h) + boff + n * 2048 + k * 1024); } while (0)
#define PG8_MMA(ai, bj, At, Bt) do { __builtin_amdgcn_s_setprio(1); _Pragma("unroll") for (int m = 0; m < 4; ++m) _Pragma("unroll") for (int n = 0; n < 2; ++n) _Pragma("unroll") for (int k = 0; k < 2; ++k) \
        acc[ai][bj][m][n] = __builtin_amdgcn_mfma_f32_16x16x32_bf16(Bt[n][k], At[m][k], acc[ai][bj][m][n], 0, 0, 0); __builtin_amdgcn_s_setprio(0); } while (0)
#define PG8_WAIT_V(n) asm volatile("s_waitcnt vmcnt(" #n ")" ::: "memory")
#define PG8_WAIT_L(n) asm volatile("s_waitcnt lgkmcnt(" #n ")" ::: "memory")
#define PG8_BAR __builtin_amdgcn_s_barrier()
#define PG8_SCHED __builtin_amdgcn_sched_barrier(0)
    Unit cur, nxt; int ui = 0;
    if (!S.next(0, cur)) return;
    f32x4 acc[2][2][4][2];
#pragma unroll
    for (int a = 0; a < 2; ++a)
#pragma unroll
        for (int b = 0; b < 2; ++b)
#pragma unroll
            for (int m = 0; m < 4; ++m)
#pragma unroll
                for (int n = 0; n < 2; ++n) acc[a][b][m][n] = (f32x4){0.f, 0.f, 0.f, 0.f};
    bf16x8 At[4][2], B0[2][2], B1[2][2];
    const char* cA = (const char*)g.A + (size_t)cur.pm * tstep; const char* cB = (const char*)g.Bt + (size_t)cur.pn * tstep;
    S.a_ready(cur);
    if constexpr (SP2) {
        PG8_STAGE(PG8_SB(0, 0), cB, voffB); PG8_STAGE(PG8_SB(0, 1), cB + hstep, voffB); PG8_STAGE(PG8_SA(0, 0), cA, voffA); PG8_STAGE(PG8_SA(0, 1), cA + hstep, voffA);
        if (wr == 1) PG8_BAR;
        PG8_WAIT_V(2); PG8_BAR;
        PG8_STAGE(PG8_SB(1, 0), cB + kstep, voffB); PG8_STAGE(PG8_SA(1, 0), cA + kstep, voffA); PG8_STAGE(PG8_SB(1, 1), cB + hstep + kstep, voffB);
        PG8_WAIT_V(6); PG8_BAR;
    } else {
        PG8_STAGE(PG8_SB(0, 0), cB, voffB); PG8_STAGE(PG8_SA(0, 0), cA, voffA); PG8_STAGE(PG8_SB(0, 1), cB + hstep, voffB); PG8_STAGE(PG8_SA(0, 1), cA + hstep, voffA);
        if (wr == 1) PG8_BAR;
        PG8_WAIT_V(4); PG8_BAR;
        PG8_STAGE(PG8_SB(1, 0), cB + kstep, voffB); PG8_STAGE(PG8_SA(1, 0), cA + kstep, voffA); PG8_STAGE(PG8_SB(1, 1), cB + hstep + kstep, voffB);
        PG8_WAIT_V(6); PG8_BAR;
    }
    for (;;) {
        const bool has_next = S.next(ui + 1, nxt);
        const char* nA = has_next ? (const char*)g.A + (size_t)nxt.pm * tstep : cA; const char* nB = has_next ? (const char*)g.Bt + (size_t)nxt.pn * tstep : cB;
        for (int t = 0; t < nt; t += 2) {
            const bool last = (t == nt - 2);
            const char* a1 = cA + (size_t)(t + 1) * kstep;
            const char* a2 = last ? nA : cA + (size_t)(t + 2) * kstep; const char* b2 = last ? nB : cB + (size_t)(t + 2) * kstep;
            const char* a3 = a2 + kstep; const char* b3 = b2 + kstep;
            if (last && has_next) S.a_ready(nxt);
            if constexpr (SP2) {
            PG8_LDB(B0, 0, 0); PG8_LDB(B1, 0, 1); PG8_SCHED; PG8_LDA(At, 0, 0); PG8_STAGE(PG8_SA(1, 1), a1 + hstep, voffA);
            PG8_WAIT_V(8); PG8_WAIT_L(0); PG8_BAR; PG8_MMA(0, 0, At, B0); PG8_MMA(0, 1, At, B1); PG8_BAR; PG8_SCHED;
            PG8_LDA(At, 0, 1); PG8_STAGE(PG8_SB(0, 0), b2, voffB); PG8_STAGE(PG8_SB(0, 1), b2 + hstep, voffB); PG8_STAGE(PG8_SA(0, 0), a2, voffA);
            PG8_WAIT_V(8); PG8_WAIT_L(0); PG8_BAR; PG8_MMA(1, 0, At, B0); PG8_MMA(1, 1, At, B1); PG8_BAR; PG8_SCHED;
            PG8_LDB(B0, 1, 0); PG8_LDB(B1, 1, 1); PG8_SCHED; PG8_LDA(At, 1, 0); PG8_STAGE(PG8_SA(0, 1), a2 + hstep, voffA);
            PG8_WAIT_V(8); PG8_WAIT_L(0); PG8_BAR; PG8_MMA(0, 0, At, B0); PG8_MMA(0, 1, At, B1); PG8_BAR; PG8_SCHED;
            PG8_LDA(At, 1, 1); PG8_STAGE(PG8_SB(1, 0), b3, voffB); PG8_STAGE(PG8_SB(1, 1), b3 + hstep, voffB); PG8_STAGE(PG8_SA(1, 0), a3, voffA);
            PG8_WAIT_V(8); PG8_WAIT_L(0); PG8_BAR; PG8_MMA(1, 0, At, B0); PG8_MMA(1, 1, At, B1); PG8_BAR; PG8_SCHED;
            } else {
            PG8_LDB(B0, 0, 0); PG8_SCHED; PG8_LDA(At, 0, 0); PG8_STAGE(PG8_SA(1, 1), a1 + hstep, voffA);
            PG8_WAIT_L(8); PG8_BAR; PG8_WAIT_L(0); PG8_MMA(0, 0, At, B0); PG8_BAR; PG8_SCHED;
            PG8_LDB(B1, 0, 1); PG8_STAGE(PG8_SB(0, 0), b2, voffB);
            PG8_BAR; PG8_WAIT_L(0); PG8_MMA(0, 1, At, B1); PG8_BAR;
            PG8_LDA(At, 0, 1); PG8_STAGE(PG8_SA(0, 0), a2, voffA);
            PG8_BAR; PG8_WAIT_L(0); PG8_MMA(1, 0, At, B0); PG8_BAR; PG8_SCHED;
            PG8_STAGE(PG8_SB(0, 1), b2 + hstep, voffB);
            PG8_WAIT_V(6); PG8_BAR; PG8_MMA(1, 1, At, B1); PG8_BAR;
            PG8_LDB(B0, 1, 0); PG8_SCHED; PG8_LDA(At, 1, 0); PG8_STAGE(PG8_SA(0, 1), a2 + hstep, voffA);
            PG8_WAIT_L(8); PG8_BAR; PG8_WAIT_L(0); PG8_MMA(0, 0, At, B0); PG8_BAR; PG8_SCHED;
            PG8_LDB(B1, 1, 1); PG8_STAGE(PG8_SB(1, 0), b3, voffB);
            PG8_BAR; PG8_WAIT_L(0); PG8_MMA(0, 1, At, B1); PG8_BAR;
            PG8_LDA(At, 1, 1); PG8_STAGE(PG8_SA(1, 0), a3, voffA);
            PG8_BAR; PG8_WAIT_L(0); PG8_MMA(1, 0, At, B0); PG8_BAR; PG8_SCHED;
            PG8_STAGE(PG8_SB(1, 1), b3 + hstep, voffB);
            PG8_WAIT_V(6); PG8_BAR; PG8_MMA(1, 1, At, B1); PG8_BAR;
            }
        }
        if constexpr (ALIGN_EPI) { if (wr == 0) PG8_BAR; }
        if constexpr (!Epi::AFTER_DRAIN) { E(acc, cur, wr, wc, fr, fq); S.done(cur); }
        if (!has_next) break;
#pragma unroll
        for (int a = 0; a < 2; ++a)
#pragma unroll
            for (int b = 0; b < 2; ++b)
#pragma unroll
                for (int m = 0; m < 4; ++m)
#pragma unroll
                    for (int n = 0; n < 2; ++n) acc[a][b][m][n] = (f32x4){0.f, 0.f, 0.f, 0.f};
        cur = nxt; cA = nA; cB = nB; ++ui;
        if constexpr (ALIGN_EPI) { if (wr == 1) PG8_BAR; }
    }
    PG8_WAIT_V(0);
    if constexpr (!ALIGN_EPI) { if (wr == 0) PG8_BAR; }
    PG8_BAR;
    if constexpr (Epi::AFTER_DRAIN) { E.fused(acc, cur, wr, wc, fr, fq, lds, wid, lane); S.done(cur); }
#undef PG8_SA
#undef PG8_SB
#undef PG8_STAGE
#undef PG8_LDA
#undef PG8_LDB
#undef PG8_MMA
#undef PG8_WAIT_V
#undef PG8_WAIT_L
#undef PG8_BAR
#undef PG8_SCHED
}
}

#ifndef PG8_SP2
#define PG8_SP2 true
#endif
#ifndef PG8_ALIGN
#define PG8_ALIGN true
#endif
#ifndef MK_PER_PHASE
#define MK_PER_PHASE 1
#endif

constexpr int NWAVES = 8;
constexpr int NB = 2, SEQ = 8192, DM = 1024, M = NB * SEQ, CTXL = 256, MC = NB * CTXL, MA = M + MC;
constexpr int NZ = 3584, FF = 2816, NGU = 2 * FF;
constexpr int NCH = SEQ / 128, NCC = CTXL / 128, NSLOT = NCH + NCC, NH = 4;
constexpr float RMS_EPS = 1e-6f;
constexpr int N_PHASES = 10;

constexpr size_t MiB = 1u << 20;
constexpr size_t WS_CTL = 0, CTL_ZERO_BYTES = 1 * MiB;
constexpr size_t WS_MODF = 1 * MiB;
constexpr size_t WS_BIASGU = WS_MODF + 128 * 1024;
constexpr size_t WS_ROPE = WS_BIASGU + 64 * 1024;
constexpr size_t WS_SGW = WS_ROPE + 64 * 1024;
constexpr size_t WS_PS1 = 4 * MiB;
constexpr size_t WS_W1T = 6 * MiB;
constexpr size_t WS_WOT = 13 * MiB;
constexpr size_t WS_WGUT = 15 * MiB;
constexpr size_t WS_WDT = 26 * MiB;
constexpr size_t WS_HX = 32 * MiB;
constexpr size_t WS_Y = WS_HX;
constexpr size_t WS_Z = 65 * MiB;
constexpr size_t WS_HH = WS_Z;
constexpr size_t WS_ZC = 177 * MiB;
constexpr size_t WS_US = 178 * MiB;
constexpr size_t WS_A2 = 211 * MiB;
constexpr size_t WS_END = 243 * MiB;
constexpr int CW_BAR = 4096;

constexpr int RING_OFF = 0, RING_BYTES = 131072;
constexpr int LDSCTL_OFF = RING_BYTES, MISC_OFF = LDSCTL_OFF + 320;
constexpr int LDS_BYTES = 147456;

#define GAS __attribute__((address_space(1)))
#define LAS __attribute__((address_space(3)))
#define DI __device__ __forceinline__
typedef unsigned short bf16;
typedef unsigned v4u __attribute__((ext_vector_type(4)));
typedef unsigned v2u __attribute__((ext_vector_type(2)));
typedef float f32x4 __attribute__((ext_vector_type(4)));
typedef float f32x2 __attribute__((ext_vector_type(2)));
typedef short bf16x8 __attribute__((ext_vector_type(8)));
typedef short s16x4 __attribute__((ext_vector_type(4)));
typedef GAS unsigned gu32;
#define RLX_AGENT __ATOMIC_RELAXED, __HIP_MEMORY_SCOPE_AGENT
#define LDS_WAIT() asm volatile("s_waitcnt lgkmcnt(0)" ::: "memory")
#define VM_WAIT() asm volatile("s_waitcnt vmcnt(0)" ::: "memory")
using pg8::cvt_pk_bf16;
DI float bf_lo(unsigned u) { return __uint_as_float(u << 16); }
DI float bf_hi(unsigned u) { return __uint_as_float(u & 0xffff0000u); }
DI float silu_f(float x) { return x * __builtin_amdgcn_rcpf(1.0f + __builtin_amdgcn_exp2f(-1.4426950408889634f * x)); }
DI float gelu_tanh_f(float x) { const float t = x + 0.044715f * x * x * x; return x * __builtin_amdgcn_rcpf(1.0f + __builtin_amdgcn_exp2f(-2.302208198f * t)); }
DI float wave_sum(float v) {
#pragma unroll
    for (int o = 1; o < 64; o <<= 1) v += __shfl_xor(v, o);
    return v;
}
DI float log_sigmoid_f(float x) { return -log1pf(expf(-x)); }

#define XB_TMO      128
#define XB_XCNT(j)  (256  + 64 * (j))
#define XB_XSUB(j)  (1280 + 64 * (j))
#define XB_XGEN(j)  (2304 + 64 * (j))
#define XB_TOP      3328
#define XB_TOPGEN   3392
#define XCD_BAR_WORDS 3456
#define XB_SPIN_CAP (1u << 18)

__device__ __forceinline__ unsigned xb_ld(unsigned* p)              { return __hip_atomic_load(p, __ATOMIC_RELAXED, __HIP_MEMORY_SCOPE_AGENT); }
__device__ __forceinline__ unsigned xb_add(unsigned* p, unsigned v) { return __hip_atomic_fetch_add(p, v, __ATOMIC_RELAXED, __HIP_MEMORY_SCOPE_AGENT); }
__device__ __forceinline__ unsigned xb_xcc_id() { return (unsigned)__builtin_amdgcn_s_getreg((3 << 11) | 20) & 0xFu; }
#define XB_SPIN(cond, bar) do { unsigned _sp = 0; while (cond) { __builtin_amdgcn_s_sleep(1); \
    if ((++_sp & 255u) == 0u) { if (xb_ld(&(bar)[XB_TMO])) break; if (_sp > XB_SPIN_CAP) { atomicAdd(&(bar)[XB_TMO], 1u); break; } } } } while (0)

struct XcdBarrier {
    unsigned* bar; unsigned x;
    volatile LAS unsigned* st;
};

__device__ __forceinline__ XcdBarrier xcd_barrier_post(unsigned* bar, volatile LAS unsigned* st) {
    XcdBarrier b; b.bar = bar; b.x = xb_xcc_id(); b.st = st;
    if (threadIdx.x == 0) (void)xb_add(&bar[XB_XCNT(b.x)], 1u);
    return b;
}
__device__ __forceinline__ void xcd_barrier_complete(unsigned* bar, unsigned x, unsigned& nloc, unsigned& nx) {
    const unsigned G = gridDim.x * gridDim.y * gridDim.z;
    unsigned sum, cnt, mine, sp = 0u;
    for (;;) {
        sum = 0u; cnt = 0u; mine = 0u;
#pragma unroll
        for (unsigned j = 0; j < 16; ++j) { const unsigned c = xb_ld(&bar[XB_XCNT(j)]); sum += c; cnt += (c > 0u) ? 1u : 0u; mine = (j == x) ? c : mine; }
        if (sum == G) break;
        __builtin_amdgcn_s_sleep(1);
        if ((++sp & 255u) == 0u) { if (xb_ld(&bar[XB_TMO])) break; if (sp > XB_SPIN_CAP) { atomicAdd(&bar[XB_TMO], 1u); break; } }
    }
    nloc = mine > 0u ? mine : 1u; nx = cnt > 0u ? cnt : 1u;
}

__device__ __forceinline__ void xcd_barrier(const XcdBarrier& b) {
    asm volatile("s_waitcnt vmcnt(0)" ::: "memory");
    __syncthreads();
    if (threadIdx.x == 0) {
        unsigned* bar = b.bar;
        __builtin_amdgcn_s_waitcnt(0);
        unsigned nloc = b.st[0], nx = b.st[1];
        if (nloc == 0u) { xcd_barrier_complete(bar, b.x, nloc, nx); b.st[0] = nloc; b.st[1] = nx; }
        const unsigned old = xb_add(&bar[XB_XSUB(b.x)], 1u);
        const unsigned gen = old / nloc;
        if (old + 1u == (gen + 1u) * nloc) {
            __builtin_amdgcn_fence(__ATOMIC_RELEASE, "agent");
            asm volatile("s_waitcnt vmcnt(0)" ::: "memory");
            const unsigned og = xb_add(&bar[XB_TOP], 1u);
            const unsigned tg = og / nx;
            if (og + 1u == (tg + 1u) * nx) xb_add(&bar[XB_TOPGEN], 1u);
            else XB_SPIN(xb_ld(&bar[XB_TOPGEN]) == tg, bar);
            __builtin_amdgcn_fence(__ATOMIC_ACQUIRE, "agent");
            xb_add(&bar[XB_XGEN(b.x)], 1u);
            asm volatile("s_waitcnt vmcnt(0)" ::: "memory");
        } else {
            XB_SPIN(xb_ld(&bar[XB_XGEN(b.x)]) == gen, bar);
            __builtin_amdgcn_fence(__ATOMIC_ACQUIRE, "agent");
            asm volatile("s_waitcnt vmcnt(0)" ::: "memory");
        }
    }
    __syncthreads();
}


struct Frame {
    LAS unsigned char* lds;
    volatile LAS unsigned* MISC;
    gu32* ctl;
    int tid, lane, wave, vcu, G;
    const float* in[19]; float* out; unsigned char* ws;
};

DI int map_w1(int n) {
    if (n < 1024 || n >= 2048) return n;
    const int t = n & ~255, c = n & 255, hh = c >> 7, d = c & 127, half = d >> 6, dd = d & 63, part = dd >> 5, f = dd & 31;
    return t + part * 128 + hh * 64 + half * 32 + f;
}
template <int MODE> DI int rowmap(int n) {
    if (MODE == 1) return map_w1(n);
    if (MODE == 2) return (n >> 7) * 256 + (n & 127);
    if (MODE == 3) return (n >> 7) * 256 + 128 + (n & 127);
    return n;
}
template <int MODE> DI void p0_transpose_item(const float* W, int K, int N, bf16* WT, LAS float* scr, int item, int lane) {
    const int nblk = N / 32, kb = item / nblk, nb = item % nblk, k0 = 64 * kb, n0 = 32 * nb;
#pragma unroll 8
    for (int i = 0; i < 32; ++i) { const int kk = 2 * i + (lane >> 5); scr[kk * 33 + (lane & 31)] = W[(size_t)(k0 + kk) * N + n0 + (lane & 31)]; }
    LDS_WAIT(); asm volatile("" ::: "memory");
    const int c = lane & 7;
#pragma unroll
    for (int j = 0; j < 4; ++j) { const int n = (lane >> 3) + 8 * j; const LAS float* s = scr + (8 * c) * 33 + n;
        v4u o; o.x = cvt_pk_bf16(s[0 * 33], s[1 * 33]); o.y = cvt_pk_bf16(s[2 * 33], s[3 * 33]); o.z = cvt_pk_bf16(s[4 * 33], s[5 * 33]); o.w = cvt_pk_bf16(s[6 * 33], s[7 * 33]);
        *(GAS v4u*)(WT + (size_t)rowmap<MODE>(n0 + n) * K + k0 + 8 * c) = o; }
    LDS_WAIT(); asm volatile("" ::: "memory");
}
DI void p0_prologue(Frame& F) {
    const float* c = F.in[1]; const float* c_ctx = F.in[3]; const float* w_mod = F.in[4]; const float* b_mod = F.in[5];
    float* MODF = (float*)(F.ws + WS_MODF);
    {
        LAS f32x4* red = (LAS f32x4*)(F.lds + RING_OFF);
        for (int grp = F.vcu; grp < 256; grp += F.G) {
            const int t = F.tid, c4 = t % 6, kr = t / 6;
            f32x4 a0 = {0.f, 0.f, 0.f, 0.f}, a1 = a0, a2 = a0;
            if (t < 510) {
                for (int k = kr; k < DM; k += 85) {
                    const f32x4 w = *(const GAS f32x4*)(w_mod + (size_t)k * 6144 + 24 * grp + 4 * c4);
                    const float s0 = silu_f(c[k]), s1 = silu_f(c[DM + k]), s2 = silu_f(c_ctx[k]);
                    a0 += w * s0; a1 += w * s1; a2 += w * s2;
                }
                red[(kr * 6 + c4) * 3 + 0] = a0; red[(kr * 6 + c4) * 3 + 1] = a1; red[(kr * 6 + c4) * 3 + 2] = a2;
            }
            __syncthreads();
            if (t < 72) {
                const int r = t / 24, cc = t % 24; const LAS float* rf = (const LAS float*)red;
                float s = 0.f;
                for (int k2 = 0; k2 < 85; ++k2) s += rf[((k2 * 6 + (cc >> 2)) * 3 + r) * 4 + (cc & 3)];
                MODF[r * 6144 + 24 * grp + cc] = s + b_mod[24 * grp + cc];
            }
            __syncthreads();
        }
    }
    {
        LAS float* scr = (LAS float*)(F.lds + RING_OFF + F.wave * 16384);
        const int gw = F.vcu * NWAVES + F.wave, NGW = F.G * NWAVES;
        constexpr int I_IN = (DM / 64) * (NZ / 32), I_O = (DM / 64) * (DM / 32), I_G = (DM / 64) * (FF / 32), I_D = (FF / 64) * (DM / 32);
        constexpr int NITEMS = I_IN + I_O + 2 * I_G + I_D;
        bf16* W1T = (bf16*)(F.ws + WS_W1T); bf16* WOT = (bf16*)(F.ws + WS_WOT); bf16* WGUT = (bf16*)(F.ws + WS_WGUT); bf16* WDT = (bf16*)(F.ws + WS_WDT);
        for (int it = gw; it < NITEMS; it += NGW) {
            int r = it;
            if (r < I_IN) { p0_transpose_item<1>(F.in[7], DM, NZ, W1T, scr, r, F.lane); continue; } r -= I_IN;
            if (r < I_O) { p0_transpose_item<0>(F.in[13], DM, DM, WOT, scr, r, F.lane); continue; } r -= I_O;
            if (r < I_G) { p0_transpose_item<2>(F.in[15], DM, FF, WGUT, scr, r, F.lane); continue; } r -= I_G;
            if (r < I_G) { p0_transpose_item<3>(F.in[16], DM, FF, WGUT, scr, r, F.lane); continue; } r -= I_G;
            p0_transpose_item<0>(F.in[17], FF, DM, WDT, scr, r, F.lane);
        }
    }
    {
        const int gt = F.vcu * (NWAVES * 64) + F.tid, NT = F.G * NWAVES * 64;
        float* rope = (float*)(F.ws + WS_ROPE);
        for (int idx = gt; idx < 4096; idx += NT) { const int pos = idx >> 5, f = idx & 31; const float inv = powf(10000.0f, -(float)f / 32.0f); const float ang = (float)pos * inv;
            rope[2 * idx] = cosf(ang); rope[2 * idx + 1] = sinf(ang); }
        bf16* sgw = (bf16*)(F.ws + WS_SGW); const float* sg_w = F.in[9];
        for (int idx = gt; idx < 32768; idx += NT) { ((unsigned*)sgw)[idx] = cvt_pk_bf16(sg_w[2 * idx], sg_w[2 * idx + 1]); }
    }
}

DI void p1_prepass(Frame& F) {
    const float* MODF = (const float*)(F.ws + WS_MODF); const float* norm1 = F.in[6];
    LAS float* GM = (LAS float*)(F.lds + RING_OFF);
    LAS float* SH = GM + 3 * DM;
    for (int i = F.tid; i < 3 * DM; i += NWAVES * 64) { const int r = i >> 10, k = i & 1023; GM[i] = norm1[k] * (1.0f + MODF[r * 6144 + 1024 + k]); SH[i] = MODF[r * 6144 + k]; }
    __syncthreads();
    bf16* HX = (bf16*)(F.ws + WS_HX);
    const int rpb = (MA + F.G - 1) / F.G, r0 = F.vcu * rpb, r1 = (r0 + rpb < MA) ? r0 + rpb : MA;
    for (int row = r0 + F.wave; row < r1; row += NWAVES) {
        const int r = row < SEQ ? 0 : (row < M ? 1 : 2);
        const float* src = row < M ? F.in[0] + (size_t)row * DM : F.in[2] + (size_t)(row - M) * DM;
        const GAS f32x4* xr = (const GAS f32x4*)src + F.lane;
        f32x4 v[4]; float s = 0.f;
#pragma unroll
        for (int j = 0; j < 4; ++j) { v[j] = xr[64 * j]; s += (v[j].x * v[j].x + v[j].y * v[j].y) + (v[j].z * v[j].z + v[j].w * v[j].w); }
        const float rstd = 1.0f / sqrtf(wave_sum(s) * (1.0f / DM) + RMS_EPS);
        GAS v2u* o8 = (GAS v2u*)(HX + (size_t)row * DM) + F.lane;
#pragma unroll
        for (int j = 0; j < 4; ++j) { const f32x4 g = *(const LAS f32x4*)(GM + r * DM + 4 * F.lane + 256 * j), sh = *(const LAS f32x4*)(SH + r * DM + 4 * F.lane + 256 * j);
            const f32x4 o = v[j] * rstd * g + sh; v2u w; w.x = cvt_pk_bf16(o.x, o.y); w.y = cvt_pk_bf16(o.z, o.w); o8[64 * j] = w; }
    }
    {
        const bf16* WGUT = (const bf16*)(F.ws + WS_WGUT); float* BIAS = (float*)(F.ws + WS_BIASGU);
        const int gw = F.vcu * NWAVES + F.wave, NGW = F.G * NWAVES;
        for (int n = gw; n < NGU; n += NGW) {
            float s0 = 0.f, s1 = 0.f;
#pragma unroll
            for (int j = 0; j < 2; ++j) { const int k = 8 * F.lane + 512 * j; const v4u w = *(const GAS v4u*)(WGUT + (size_t)n * DM + k);
                const f32x4 a0 = *(const GAS f32x4*)(MODF + 0 * 6144 + 3072 + k), a1 = *(const GAS f32x4*)(MODF + 0 * 6144 + 3072 + k + 4);
                const f32x4 b0 = *(const GAS f32x4*)(MODF + 1 * 6144 + 3072 + k), b1 = *(const GAS f32x4*)(MODF + 1 * 6144 + 3072 + k + 4);
                const float w0 = bf_lo(w.x), w1 = bf_hi(w.x), w2 = bf_lo(w.y), w3 = bf_hi(w.y), w4 = bf_lo(w.z), w5 = bf_hi(w.z), w6 = bf_lo(w.w), w7 = bf_hi(w.w);
                s0 += w0 * a0.x + w1 * a0.y + w2 * a0.z + w3 * a0.w + w4 * a1.x + w5 * a1.y + w6 * a1.z + w7 * a1.w;
                s1 += w0 * b0.x + w1 * b0.y + w2 * b0.z + w3 * b0.w + w4 * b1.x + w5 * b1.y + w6 * b1.z + w7 * b1.w; }
            s0 = wave_sum(s0); s1 = wave_sum(s1);
            if (F.lane == 0) { BIAS[n] = s0; BIAS[NGU + n] = s1; }
        }
    }
}

struct OrderG1 {
    pg8::StaticOrder so; int G, c;
    __device__ bool next(int i, pg8::Unit& u) const {
        const long Lx = (long)i * G + c;
        if (Lx < 896) return so.next(i, u);
        const int e = (int)(Lx - 896); if (e >= 8) return false;
        u.pm = 64 + (e >> 2); u.pn = 6 + (e & 3); return true;
    }
    DI void a_ready(const pg8::Unit&) const {}
    DI void done(const pg8::Unit&) const {}
};
struct EpiZ {
    static constexpr bool PERM = true, AFTER_DRAIN = false;
    bf16* Z; bf16* ZC; const float* rope;
    DI void operator()(const f32x4 (&acc)[2][2][4][2], const pg8::Unit& u, int wr, int wc, int fr, int fq) const {
        const int pn = u.pn; const bool isctx = u.pm >= 64;
        const int row0 = u.pm * 256 + wr * 64 + fr;
        if (pn >= 4 && pn < 8) {
            const float scale = pn >= 6 ? 0.08838834764831845f : 1.0f;
#pragma unroll
            for (int ai = 0; ai < 2; ++ai)
#pragma unroll
                for (int m = 0; m < 4; ++m) {
                    const int row = row0 + ai * 128 + m * 16;
                    const f32x4 a0 = acc[ai][0][m][0], a1 = acc[ai][0][m][1], b0 = acc[ai][1][m][0], b1 = acc[ai][1][m][1];
                    f32x4 o10, o11, o20, o21;
                    bf16* dst;
                    if (!isctx) {
                        const int l = row & (SEQ - 1); const int pos = (wc & 1) ? (l & 63) : (l >> 6);
                        const GAS f32x4* cs = (const GAS f32x4*)(rope + (size_t)(pos * 32 + 8 * fq) * 2);
                        const f32x4 t0 = cs[0], t1 = cs[1], t2 = cs[2], t3 = cs[3];
                        const f32x4 co0 = {t0.x, t0.z, t1.x, t1.z}, si0 = {t0.y, t0.w, t1.y, t1.w}, co1 = {t2.x, t2.z, t3.x, t3.z}, si1 = {t2.y, t2.w, t3.y, t3.w};
                        o10 = (a0 * co0 - b0 * si0) * scale; o11 = (a1 * co1 - b1 * si1) * scale;
                        o20 = (a0 * si0 + b0 * co0) * scale; o21 = (a1 * si1 + b1 * co1) * scale;
                        dst = Z + (size_t)row * NZ + 256 * pn + 64 * wc + 8 * fq;
                    } else {
                        o10 = a0 * scale; o11 = a1 * scale; o20 = b0 * scale; o21 = b1 * scale;
                        dst = ZC + (size_t)(row - M) * 1024 + (256 * pn - 1536) + 64 * wc + 8 * fq;
                    }
                    v4u w1, w2;
                    w1.x = cvt_pk_bf16(o10[0], o10[1]); w1.y = cvt_pk_bf16(o10[2], o10[3]); w1.z = cvt_pk_bf16(o11[0], o11[1]); w1.w = cvt_pk_bf16(o11[2], o11[3]);
                    w2.x = cvt_pk_bf16(o20[0], o20[1]); w2.y = cvt_pk_bf16(o20[2], o20[3]); w2.z = cvt_pk_bf16(o21[0], o21[1]); w2.w = cvt_pk_bf16(o21[2], o21[3]);
                    *(GAS v4u*)dst = w1; *(GAS v4u*)(dst + 32) = w2;
                }
        } else {
            const int act = pn < 4 ? 1 : (pn >= 10 ? 2 : 0);
#pragma unroll
            for (int ai = 0; ai < 2; ++ai)
#pragma unroll
                for (int m = 0; m < 4; ++m) {
                    const int row = row0 + ai * 128 + m * 16;
                    bf16* dst = !isctx ? Z + (size_t)row * NZ + 256 * pn + 32 * wc + 8 * fq : ZC + (size_t)(row - M) * 1024 + 512 + 256 * (pn - 8) + 32 * wc + 8 * fq;
#pragma unroll
                    for (int bj = 0; bj < 2; ++bj) {
                        f32x4 v0 = acc[ai][bj][m][0], v1 = acc[ai][bj][m][1];
                        if (act == 1) { v0 = (f32x4){gelu_tanh_f(v0[0]), gelu_tanh_f(v0[1]), gelu_tanh_f(v0[2]), gelu_tanh_f(v0[3])}; v1 = (f32x4){gelu_tanh_f(v1[0]), gelu_tanh_f(v1[1]), gelu_tanh_f(v1[2]), gelu_tanh_f(v1[3])}; }
                        else if (act == 2) { v0 = (f32x4){silu_f(v0[0]), silu_f(v0[1]), silu_f(v0[2]), silu_f(v0[3])}; v1 = (f32x4){silu_f(v1[0]), silu_f(v1[1]), silu_f(v1[2]), silu_f(v1[3])}; }
                        v4u w; w.x = cvt_pk_bf16(v0[0], v0[1]); w.y = cvt_pk_bf16(v0[2], v0[3]); w.z = cvt_pk_bf16(v1[0], v1[1]); w.w = cvt_pk_bf16(v1[2], v1[3]);
                        *(GAS v4u*)(dst + bj * 128) = w;
                    }
                }
        }
    }
};
struct EpiX1 {
    static constexpr bool PERM = true, AFTER_DRAIN = false;
    const float* x; float* x1; bf16* A2; const float* MODF; const float* norm2; float* PS1;
    DI void operator()(const f32x4 (&acc)[2][2][4][2], const pg8::Unit& u, int wr, int wc, int fr, int fq) const {
        const int b = u.pm >= 32 ? 1 : 0; const int col0 = u.pn * 256 + wc * 32 + 8 * fq; const int row0 = u.pm * 256 + wr * 64 + fr;
        f32x4 g1v[2][2], gm2[2][2];
#pragma unroll
        for (int bj = 0; bj < 2; ++bj)
#pragma unroll
            for (int n = 0; n < 2; ++n) { const int c = col0 + bj * 128 + 4 * n;
                g1v[bj][n] = *(const GAS f32x4*)(MODF + b * 6144 + 2048 + c);
                gm2[bj][n] = *(const GAS f32x4*)(norm2 + c) * (*(const GAS f32x4*)(MODF + b * 6144 + 4096 + c) + 1.0f); }
#pragma unroll
        for (int ai = 0; ai < 2; ++ai)
#pragma unroll
            for (int m = 0; m < 4; ++m) {
                const int row = row0 + ai * 128 + m * 16; float ss = 0.f;
#pragma unroll
                for (int bj = 0; bj < 2; ++bj) {
                    const size_t off = (size_t)row * DM + col0 + bj * 128;
                    const f32x4 xa = *(const GAS f32x4*)(x + off), xb = *(const GAS f32x4*)(x + off + 4);
                    const f32x4 ya = xa + g1v[bj][0] * acc[ai][bj][m][0], yb = xb + g1v[bj][1] * acc[ai][bj][m][1];
                    *(GAS f32x4*)(x1 + off) = ya; *(GAS f32x4*)(x1 + off + 4) = yb;
                    ss += (ya.x * ya.x + ya.y * ya.y) + (ya.z * ya.z + ya.w * ya.w) + (yb.x * yb.x + yb.y * yb.y) + (yb.z * yb.z + yb.w * yb.w);
                    const f32x4 pa = ya * gm2[bj][0], pb = yb * gm2[bj][1];
                    v4u w; w.x = cvt_pk_bf16(pa[0], pa[1]); w.y = cvt_pk_bf16(pa[2], pa[3]); w.z = cvt_pk_bf16(pb[0], pb[1]); w.w = cvt_pk_bf16(pb[2], pb[3]);
                    *(GAS v4u*)(A2 + off) = w;
                }
                ss += __shfl_xor(ss, 16); ss += __shfl_xor(ss, 32);
                if (fq == 0) PS1[(size_t)(u.pn * 4 + wc) * M + row] = ss;
            }
    }
};
struct EpiSw {
    static constexpr bool PERM = true, AFTER_DRAIN = false;
    bf16* HH; const float* BIAS; const float* PS1;
    DI void operator()(const f32x4 (&acc)[2][2][4][2], const pg8::Unit& u, int wr, int wc, int fr, int fq) const {
        const int b = u.pm >= 32 ? 1 : 0; const int row0 = u.pm * 256 + wr * 64 + fr; const int cl = wc * 32 + 8 * fq;
        f32x4 bg[2], bu[2];
#pragma unroll
        for (int n = 0; n < 2; ++n) { bg[n] = *(const GAS f32x4*)(BIAS + b * NGU + u.pn * 256 + cl + 4 * n); bu[n] = *(const GAS f32x4*)(BIAS + b * NGU + u.pn * 256 + 128 + cl + 4 * n); }
#pragma unroll
        for (int ai = 0; ai < 2; ++ai)
#pragma unroll
            for (int m = 0; m < 4; ++m) {
                const int row = row0 + ai * 128 + m * 16; float ss = 0.f;
#pragma unroll
                for (int p = 0; p < 16; ++p) ss += PS1[(size_t)p * M + row];
                const float rstd = 1.0f / sqrtf(ss * (1.0f / DM) + RMS_EPS);
                f32x4 h[2];
#pragma unroll
                for (int n = 0; n < 2; ++n) { const f32x4 g = acc[ai][0][m][n] * rstd + bg[n], up = acc[ai][1][m][n] * rstd + bu[n];
                    h[n] = (f32x4){silu_f(g[0]) * up[0], silu_f(g[1]) * up[1], silu_f(g[2]) * up[2], silu_f(g[3]) * up[3]}; }
                v4u w; w.x = cvt_pk_bf16(h[0][0], h[0][1]); w.y = cvt_pk_bf16(h[0][2], h[0][3]); w.z = cvt_pk_bf16(h[1][0], h[1][1]); w.w = cvt_pk_bf16(h[1][2], h[1][3]);
                *(GAS v4u*)(HH + (size_t)row * FF + u.pn * 128 + cl) = w;
            }
    }
};
struct EpiX2 {
    static constexpr bool PERM = true, AFTER_DRAIN = false;
    float* x1; const float* MODF;
    DI void operator()(const f32x4 (&acc)[2][2][4][2], const pg8::Unit& u, int wr, int wc, int fr, int fq) const {
        const int b = u.pm >= 32 ? 1 : 0; const int col0 = u.pn * 256 + wc * 32 + 8 * fq; const int row0 = u.pm * 256 + wr * 64 + fr;
        f32x4 g2v[2][2];
#pragma unroll
        for (int bj = 0; bj < 2; ++bj)
#pragma unroll
            for (int n = 0; n < 2; ++n) g2v[bj][n] = *(const GAS f32x4*)(MODF + b * 6144 + 5120 + col0 + bj * 128 + 4 * n);
#pragma unroll
        for (int ai = 0; ai < 2; ++ai)
#pragma unroll
            for (int m = 0; m < 4; ++m) {
                const int row = row0 + ai * 128 + m * 16;
#pragma unroll
                for (int bj = 0; bj < 2; ++bj) {
                    const size_t off = (size_t)row * DM + col0 + bj * 128;
                    const f32x4 xa = *(const GAS f32x4*)(x1 + off), xb = *(const GAS f32x4*)(x1 + off + 4);
                    *(GAS f32x4*)(x1 + off) = xa + g2v[bj][0] * acc[ai][bj][m][0]; *(GAS f32x4*)(x1 + off + 4) = xb + g2v[bj][1] * acc[ai][bj][m][1];
                }
            }
    }
};

DI unsigned off_b(unsigned row, unsigned ch) { return 256u * row + 16u * (ch ^ (((row & 3u) << 2) | ((row >> 2) & 3u))); }
DI bf16x8 frag_row(const LAS unsigned char* tile, int rb, int ks, int lane) { return *(const LAS bf16x8*)(tile + off_b((unsigned)((lane & 15) + 16 * rb), (unsigned)(4 * ks + (lane >> 4)))); }
typedef short v4i16_t __attribute__((ext_vector_type(4)));
DI s16x4 tr_rd(const LAS unsigned char* p) { return __builtin_bit_cast(s16x4, __builtin_amdgcn_ds_read_tr16_b64_v4i16((LAS v4i16_t*)p)); }
DI bf16x8 frag_tr(const LAS unsigned char* tile, int c, int ks, int lane) {
    const unsigned g = lane >> 4, q = (lane & 15) >> 2, p = lane & 3;
    const s16x4 lo = tr_rd(tile + off_b(32u * ks + 8u * g + q, 2u * c + (p >> 1)) + 8u * (p & 1));
    const s16x4 hi = tr_rd(tile + off_b(32u * ks + 8u * g + 4u + q, 2u * c + (p >> 1)) + 8u * (p & 1));
    return __builtin_shufflevector(lo, hi, 0, 1, 2, 3, 4, 5, 6, 7);
}
#define MFMA16(a, b, c) __builtin_amdgcn_mfma_f32_16x16x32_bf16((a), (b), (c), 0, 0, 0)
template <bool LTR, bool RTR> DI void wave_mm(f32x4 (&acc)[8], const LAS unsigned char* Lt, int lrb, const LAS unsigned char* Rt, int lane) {
    asm volatile("" : "+v"(lane));
#pragma unroll 1
    for (int ks = 0; ks < 4; ++ks) {
        const bf16x8 lf = LTR ? frag_tr(Lt, lrb, ks, lane) : frag_row(Lt, lrb, ks, lane);
#pragma unroll
        for (int cb = 0; cb < 8; ++cb) { const bf16x8 rf = RTR ? frag_tr(Rt, cb, ks, lane) : frag_row(Rt, cb, ks, lane); acc[cb] = MFMA16(rf, lf, acc[cb]); }
    }
}
DI void load_tile(LAS unsigned char* tile, const bf16* src, int ld, int tid) {
#pragma unroll
    for (int i = 0; i < 4; ++i) { const int id = tid + 512 * i, row = id >> 4, ch = id & 15;
        const v4u g = *(const GAS v4u*)(src + (size_t)row * ld + ch * 8); *(LAS v4u*)(tile + off_b(row, ch)) = g; }
}
DI void zero_acc(f32x4 (&a)[8]) {
#pragma unroll
    for (int i = 0; i < 8; ++i) a[i] = (f32x4){0.f, 0.f, 0.f, 0.f};
}

DI void p3_mixer_a(Frame& F) {
    bf16* Z = (bf16*)(F.ws + WS_Z); const bf16* ZC = (const bf16*)(F.ws + WS_ZC); bf16* US = (bf16*)(F.ws + WS_US); bf16* Y = (bf16*)(F.ws + WS_Y);
    const bf16* SGW = (const bf16*)(F.ws + WS_SGW);
    LAS unsigned char* s0 = F.lds + RING_OFF; LAS unsigned char* s1 = s0 + 32768; LAS unsigned char* s2 = s0 + 65536;
    const int tid = F.tid, lane = F.lane, wave = F.wave;
    constexpr int N_UPD = 512 + 16, N_SP = 512;
    for (int job = F.vcu; job < N_UPD + N_SP; job += F.G) {
        if (job < N_UPD) {
            int b, slot, h, ld; const bf16 *Ks, *Vs;
            if (job < 512) { b = job >> 8; const int n = (job >> 2) & 63; h = job & 3; slot = NCC + n; ld = NZ;
                Ks = Z + (size_t)(b * SEQ + n * 128) * NZ + 1536 + h * 128; Vs = Ks + 512; }
            else { const int e = job - 512; b = e >> 3; const int n = (e >> 2) & 1; h = e & 3; slot = n; ld = 1024;
                Ks = ZC + (size_t)(b * CTXL + n * 128) * 1024 + h * 128; Vs = Ks + 512; }
            const float lgf = log_sigmoid_f(F.in[11][h]) * 1.4426950408889634f, lgb = log_sigmoid_f(F.in[12][h]) * 1.4426950408889634f;
            load_tile(s0, Ks, ld, tid);
#pragma unroll
            for (int i = 0; i < 4; ++i) { const int id = tid + 512 * i, row = id >> 4, ch = id & 15;
                const v4u g = *(const GAS v4u*)(Vs + (size_t)row * ld + ch * 8);
                const float wf = __builtin_amdgcn_exp2f(lgf * (float)(127 - row)), wb = __builtin_amdgcn_exp2f(lgb * (float)row);
                v4u of, ob;
                of.x = cvt_pk_bf16(bf_lo(g.x) * wf, bf_hi(g.x) * wf); of.y = cvt_pk_bf16(bf_lo(g.y) * wf, bf_hi(g.y) * wf); of.z = cvt_pk_bf16(bf_lo(g.z) * wf, bf_hi(g.z) * wf); of.w = cvt_pk_bf16(bf_lo(g.w) * wf, bf_hi(g.w) * wf);
                ob.x = cvt_pk_bf16(bf_lo(g.x) * wb, bf_hi(g.x) * wb); ob.y = cvt_pk_bf16(bf_lo(g.y) * wb, bf_hi(g.y) * wb); ob.z = cvt_pk_bf16(bf_lo(g.z) * wb, bf_hi(g.z) * wb); ob.w = cvt_pk_bf16(bf_lo(g.w) * wb, bf_hi(g.w) * wb);
                *(LAS v4u*)(s1 + off_b(row, ch)) = of; *(LAS v4u*)(s2 + off_b(row, ch)) = ob; }
            __syncthreads();
            f32x4 af[8], ab[8]; zero_acc(af); zero_acc(ab);
#pragma unroll 1
            for (int ks = 0; ks < 4; ++ks) {
                const bf16x8 lf = frag_tr(s0, wave, ks, lane);
#pragma unroll
                for (int cb = 0; cb < 8; ++cb) { af[cb] = MFMA16(frag_tr(s1, cb, ks, lane), lf, af[cb]); ab[cb] = MFMA16(frag_tr(s2, cb, ks, lane), lf, ab[cb]); }
            }
            bf16* Uf = US + ((size_t)((0 * NB + b) * NSLOT + slot) * NH + h) * 16384 + (size_t)(16 * wave + (lane & 15)) * 128 + 4 * (lane >> 4);
            bf16* Ub = US + ((size_t)((1 * NB + b) * NSLOT + slot) * NH + h) * 16384 + (size_t)(16 * wave + (lane & 15)) * 128 + 4 * (lane >> 4);
#pragma unroll
            for (int cb = 0; cb < 8; ++cb) { v2u w; w.x = cvt_pk_bf16(af[cb][0], af[cb][1]); w.y = cvt_pk_bf16(af[cb][2], af[cb][3]); *(GAS v2u*)(Uf + 16 * cb) = w;
                w.x = cvt_pk_bf16(ab[cb][0], ab[cb][1]); w.y = cvt_pk_bf16(ab[cb][2], ab[cb][3]); *(GAS v2u*)(Ub + 16 * cb) = w; }
            __syncthreads();
        } else {
            const int sj = job - N_UPD, b = sj >> 8, n = (sj >> 2) & 63, g = sj & 3;
            const size_t rbase = (size_t)(b * SEQ + n * 128);
            const float* gain = F.in[8] + g * 128; const float* sgb = F.in[10] + g * 128;
#pragma unroll
            for (int i = 0; i < 4; ++i) { const int id = tid + 512 * i, row = id >> 4, ch = id & 15;
                const v4u gg = *(const GAS v4u*)(Z + (rbase + row) * NZ + 512 + g * 128 + ch * 8);
                float x[8] = {bf_lo(gg.x), bf_hi(gg.x), bf_lo(gg.y), bf_hi(gg.y), bf_lo(gg.z), bf_hi(gg.z), bf_lo(gg.w), bf_hi(gg.w)};
                float ss = 0.f;
#pragma unroll
                for (int e = 0; e < 8; ++e) ss += x[e] * x[e];
                ss += __shfl_xor(ss, 1); ss += __shfl_xor(ss, 2); ss += __shfl_xor(ss, 4); ss += __shfl_xor(ss, 8);
                const float rstd = 1.0f / sqrtf(ss * (1.0f / 128.0f) + RMS_EPS);
                const f32x4 g0 = *(const GAS f32x4*)(gain + ch * 8), g1 = *(const GAS f32x4*)(gain + ch * 8 + 4);
                v4u o; o.x = cvt_pk_bf16(x[0] * rstd * g0.x, x[1] * rstd * g0.y); o.y = cvt_pk_bf16(x[2] * rstd * g0.z, x[3] * rstd * g0.w);
                o.z = cvt_pk_bf16(x[4] * rstd * g1.x, x[5] * rstd * g1.y); o.w = cvt_pk_bf16(x[6] * rstd * g1.z, x[7] * rstd * g1.w);
                *(LAS v4u*)(s0 + off_b(row, ch)) = o; }
            load_tile(s1, SGW + g * 16384, 128, tid);
            __syncthreads();
            f32x4 acc[8]; zero_acc(acc);
            wave_mm<false, true>(acc, s1, wave, s0, lane);
            const int p = 16 * wave + (lane & 15); const float bp = sgb[p];
            const bf16* up = Z + (rbase + p) * NZ + g * 128 + 4 * (lane >> 4);
            bf16* yp = Y + (rbase + p) * DM + g * 128 + 4 * (lane >> 4);
#pragma unroll
            for (int cb = 0; cb < 8; ++cb) { const v2u uu = *(const GAS v2u*)(up + 16 * cb);
                v2u w; w.x = cvt_pk_bf16(bf_lo(uu.x) * (acc[cb][0] + bp), bf_hi(uu.x) * (acc[cb][1] + bp)); w.y = cvt_pk_bf16(bf_lo(uu.y) * (acc[cb][2] + bp), bf_hi(uu.y) * (acc[cb][3] + bp));
                *(GAS v2u*)(yp + 16 * cb) = w; }
            __syncthreads();
        }
    }
}

DI void p4_scan(Frame& F) {
    unsigned* US = (unsigned*)(F.ws + WS_US);
    const int gt = F.vcu * (NWAVES * 64) + F.tid, NT = F.G * NWAVES * 64;
    for (int ch = gt; ch < 131072; ch += NT) {
        const int e2 = ch & 8191, h = (ch >> 13) & 3, b = (ch >> 15) & 1, dir = ch >> 16;
        const float lg = log_sigmoid_f(dir ? F.in[12][h] : F.in[11][h]); const float dec = expf(lg * 128.0f);
        unsigned* base = US + ((size_t)(dir * NB + b) * NSLOT * NH + h) * 8192 + e2;
        float sa = 0.f, sb = 0.f;
        for (int t0 = 0; t0 < NSLOT; t0 += 11) {
            unsigned v[11];
#pragma unroll
            for (int j = 0; j < 11; ++j) { const int t = t0 + j; const int slot = dir ? (t < 2 ? 1 - t : 67 - t) : t; v[j] = base[(size_t)slot * NH * 8192]; }
#pragma unroll
            for (int j = 0; j < 11; ++j) { const int t = t0 + j; const int slot = dir ? (t < 2 ? 1 - t : 67 - t) : t;
                base[(size_t)slot * NH * 8192] = cvt_pk_bf16(sa, sb);
                sa = dec * sa + bf_lo(v[j]); sb = dec * sb + bf_hi(v[j]); }
        }
    }
}

DI void p5_mixer_b(Frame& F) {
    const bf16* Z = (const bf16*)(F.ws + WS_Z); const bf16* US = (const bf16*)(F.ws + WS_US); bf16* Y = (bf16*)(F.ws + WS_Y);
    LAS unsigned char* s0 = F.lds + RING_OFF; LAS unsigned char* s1 = s0 + 32768; LAS unsigned char* s2 = s0 + 65536; LAS unsigned char* s3 = s0 + 98304;
    const int tid = F.tid, lane = F.lane, wave = F.wave;
    for (int job = F.vcu; job < 512; job += F.G) {
        const int b = job >> 8, n = (job >> 2) & 63, h = job & 3;
        const size_t rbase = (size_t)(b * SEQ + n * 128);
        const float lgf = log_sigmoid_f(F.in[11][h]) * 1.4426950408889634f, lgb = log_sigmoid_f(F.in[12][h]) * 1.4426950408889634f;
        const bf16* Sf = US + ((size_t)((0 * NB + b) * NSLOT + NCC + n) * NH + h) * 16384;
        const bf16* Sb = US + ((size_t)((1 * NB + b) * NSLOT + NCC + n) * NH + h) * 16384;
        load_tile(s0, Z + rbase * NZ + 1024 + h * 128, NZ, tid);
        load_tile(s1, Z + rbase * NZ + 1536 + h * 128, NZ, tid);
        load_tile(s2, Z + rbase * NZ + 2048 + h * 128, NZ, tid);
        load_tile(s3, Sf, 128, tid);
        __syncthreads();
        f32x4 sc[8], cf[8], in_[8];
        zero_acc(sc); zero_acc(cf);
        wave_mm<false, false>(sc, s0, wave, s1, lane);
        wave_mm<false, true>(cf, s0, wave, s3, lane);
        __syncthreads();
        load_tile(s3, Sb, 128, tid);
        int i = 16 * wave + (lane & 15);
        asm volatile("" : "+v"(i));
        const unsigned xr = ((i & 3u) << 2) | ((i >> 2) & 3u);
#pragma unroll
        for (int cb = 0; cb < 8; ++cb) { const int j0 = 16 * cb + 4 * (lane >> 4); float v[4];
#pragma unroll
            for (int r = 0; r < 4; ++r) { const int j = j0 + r; v[r] = j <= i ? sc[cb][r] * __builtin_amdgcn_exp2f(lgf * (float)(i - j)) : 0.f; }
            v2u w; w.x = cvt_pk_bf16(v[0], v[1]); w.y = cvt_pk_bf16(v[2], v[3]);
            *(LAS v2u*)(s1 + 256u * i + 16u * ((unsigned)(j0 >> 3) ^ xr) + 2u * (j0 & 7)) = w; }
        asm volatile("" ::: "memory");
        zero_acc(in_);
        wave_mm<false, true>(in_, s1, wave, s2, lane);
        { const float xf = __builtin_amdgcn_exp2f(lgf * (float)(i + 1));
#pragma unroll
          for (int cb = 0; cb < 8; ++cb) cf[cb] = in_[cb] + cf[cb] * xf; }
        __syncthreads();
        f32x4 cbk[8]; zero_acc(cbk);
        wave_mm<false, true>(cbk, s0, wave, s3, lane);
        asm volatile("" ::: "memory");
        asm volatile("" : "+v"(i));
#pragma unroll
        for (int cb = 0; cb < 8; ++cb) { const int j0 = 16 * cb + 4 * (lane >> 4); float v[4];
#pragma unroll
            for (int r = 0; r < 4; ++r) { const int j = j0 + r; v[r] = j >= i ? sc[cb][r] * __builtin_amdgcn_exp2f(lgb * (float)(j - i)) : 0.f; }
            v2u w; w.x = cvt_pk_bf16(v[0], v[1]); w.y = cvt_pk_bf16(v[2], v[3]);
            *(LAS v2u*)(s1 + 256u * i + 16u * ((unsigned)(j0 >> 3) ^ xr) + 2u * (j0 & 7)) = w; }
        asm volatile("" ::: "memory");
        zero_acc(in_);
        wave_mm<false, true>(in_, s1, wave, s2, lane);
        { const float xb = __builtin_amdgcn_exp2f(lgb * (float)(128 - i));
#pragma unroll
          for (int cb = 0; cb < 8; ++cb) cbk[cb] = in_[cb] + cbk[cb] * xb; }
        float ssf = 0.f, ssb = 0.f;
#pragma unroll
        for (int cb = 0; cb < 8; ++cb)
#pragma unroll
            for (int r = 0; r < 4; ++r) { ssf += cf[cb][r] * cf[cb][r]; ssb += cbk[cb][r] * cbk[cb][r]; }
        ssf += __shfl_xor(ssf, 16); ssf += __shfl_xor(ssf, 32); ssb += __shfl_xor(ssb, 16); ssb += __shfl_xor(ssb, 32);
        const float rf = 1.0f / sqrtf(ssf * (1.0f / 128.0f) + RMS_EPS), rb_ = 1.0f / sqrtf(ssb * (1.0f / 128.0f) + RMS_EPS);
        asm volatile("" ::: "memory");
        const bf16* gfp = Z + (rbase + i) * NZ + 2560 + h * 128 + 4 * (lane >> 4);
        const bf16* gbp = gfp + 512;
        bf16* yp = Y + (rbase + i) * DM + 512 + h * 128 + 4 * (lane >> 4);
#pragma unroll
        for (int cb = 0; cb < 8; ++cb) { const v2u a = *(const GAS v2u*)(gfp + 16 * cb), c2 = *(const GAS v2u*)(gbp + 16 * cb);
            const float y0 = bf_lo(a.x) * cf[cb][0] * rf + bf_lo(c2.x) * cbk[cb][0] * rb_, y1 = bf_hi(a.x) * cf[cb][1] * rf + bf_hi(c2.x) * cbk[cb][1] * rb_;
            const float y2 = bf_lo(a.y) * cf[cb][2] * rf + bf_lo(c2.y) * cbk[cb][2] * rb_, y3 = bf_hi(a.y) * cf[cb][3] * rf + bf_hi(c2.y) * cbk[cb][3] * rb_;
            v2u w; w.x = cvt_pk_bf16(y0, y1); w.y = cvt_pk_bf16(y2, y3); *(GAS v2u*)(yp + 16 * cb) = w; }
        __syncthreads();
    }
}

DI void p9_final(Frame& F) {
    const float* nf = F.in[18];
    const int gw = F.vcu * NWAVES + F.wave, NGW = F.G * NWAVES;
    f32x4 g[4];
#pragma unroll
    for (int j = 0; j < 4; ++j) g[j] = *(const GAS f32x4*)(nf + 4 * F.lane + 256 * j);
    for (int row = gw; row < M; row += NGW) {
        GAS f32x4* xr = (GAS f32x4*)(F.out + (size_t)row * DM) + F.lane;
        f32x4 v[4]; float s = 0.f;
#pragma unroll
        for (int j = 0; j < 4; ++j) { v[j] = xr[64 * j]; s += (v[j].x * v[j].x + v[j].y * v[j].y) + (v[j].z * v[j].z + v[j].w * v[j].w); }
        const float rstd = 1.0f / sqrtf(wave_sum(s) * (1.0f / DM) + RMS_EPS);
#pragma unroll
        for (int j = 0; j < 4; ++j) xr[64 * j] = v[j] * rstd * g[j];
    }
}

struct Args { const float* in[19]; float* out; unsigned char* ws; int ph_lo, ph_hi; };
__global__ void __launch_bounds__(NWAVES * 64, 2) fwd_kernel(Args args) {
    extern __shared__ __attribute__((aligned(16))) unsigned char lds[];
    Frame F;
    F.lds = (LAS unsigned char*)lds;
    F.MISC = (volatile LAS unsigned*)(F.lds + MISC_OFF);
    F.tid = threadIdx.x; F.lane = F.tid & 63; F.wave = __builtin_amdgcn_readfirstlane(F.tid >> 6);
    F.G = gridDim.x; { const int bx = blockIdx.x; F.vcu = (F.G % 8 == 0) ? (bx % 8) * (F.G / 8) + bx / 8 : bx; }
#pragma unroll
    for (int i = 0; i < 19; ++i) F.in[i] = args.in[i];
    F.out = args.out; F.ws = args.ws;
    F.ctl = (gu32*)(args.ws + WS_CTL);
    for (int u = F.tid; u < (LDS_BYTES - LDSCTL_OFF) / 4; u += NWAVES * 64) ((LAS unsigned*)(F.lds + LDSCTL_OFF))[u] = 0u;
    __syncthreads();
    XcdBarrier bar; bar.bar = (unsigned*)(F.ctl + CW_BAR); bar.x = 0; bar.st = nullptr;
#if !MK_PER_PHASE
    bar = xcd_barrier_post((unsigned*)(F.ctl + CW_BAR), F.MISC + 8);
#endif
    const int lo = args.ph_lo, hi = args.ph_hi;
#define IN(k) (lo <= (k) && (k) < hi)
#define SEAM(k) do { if (IN(k) && IN((k) + 1)) xcd_barrier(bar); } while (0)

    if (IN(0)) { p0_prologue(F); } SEAM(0);
    if (IN(1)) { p1_prepass(F); } SEAM(1);
    if (IN(2)) {
        pg8::Gemm g{(const bf16*)(F.ws + WS_HX), (const bf16*)(F.ws + WS_W1T), MA, NZ, DM};
        OrderG1 S; S.so.init(M, NZ, F.G, (int)blockIdx.x); S.G = F.G; S.c = (int)blockIdx.x;
        EpiZ E{(bf16*)(F.ws + WS_Z), (bf16*)(F.ws + WS_ZC), (const float*)(F.ws + WS_ROPE)};
        pg8::gemm_phase<EpiZ, OrderG1, PG8_ALIGN, PG8_SP2>(F.lds + RING_OFF, g, S, E);
    } SEAM(2);
    if (IN(3)) { p3_mixer_a(F); } SEAM(3);
    if (IN(4)) { p4_scan(F); } SEAM(4);
    if (IN(5)) { p5_mixer_b(F); } SEAM(5);
    if (IN(6)) {
        pg8::Gemm g{(const bf16*)(F.ws + WS_Y), (const bf16*)(F.ws + WS_WOT), M, DM, DM};
        pg8::StaticOrder S; S.init(M, DM, F.G, (int)blockIdx.x);
        EpiX1 E{F.in[0], F.out, (bf16*)(F.ws + WS_A2), (const float*)(F.ws + WS_MODF), F.in[14], (float*)(F.ws + WS_PS1)};
        pg8::gemm_phase<EpiX1, pg8::StaticOrder, PG8_ALIGN, PG8_SP2>(F.lds + RING_OFF, g, S, E);
    } SEAM(6);
    if (IN(7)) {
        pg8::Gemm g{(const bf16*)(F.ws + WS_A2), (const bf16*)(F.ws + WS_WGUT), M, NGU, DM};
        pg8::StaticOrder S; S.init(M, NGU, F.G, (int)blockIdx.x);
        EpiSw E{(bf16*)(F.ws + WS_HH), (const float*)(F.ws + WS_BIASGU), (const float*)(F.ws + WS_PS1)};
        pg8::gemm_phase<EpiSw, pg8::StaticOrder, PG8_ALIGN, PG8_SP2>(F.lds + RING_OFF, g, S, E);
    } SEAM(7);
    if (IN(8)) {
        pg8::Gemm g{(const bf16*)(F.ws + WS_HH), (const bf16*)(F.ws + WS_WDT), M, DM, FF};
        pg8::StaticOrder S; S.init(M, DM, F.G, (int)blockIdx.x);
        EpiX2 E{F.out, (const float*)(F.ws + WS_MODF)};
        pg8::gemm_phase<EpiX2, pg8::StaticOrder, PG8_ALIGN, PG8_SP2>(F.lds + RING_OFF, g, S, E);
    } SEAM(8);
    if (IN(9)) { p9_final(F); }
#undef IN
#undef SEAM
}

extern "C" void kernel_launch(void* const* d_in, const int* in_sizes, int n_in, void* d_out, int out_size, void* d_ws, size_t ws_size, hipStream_t stream) {
    static int grid = 0;
    if (grid == 0) {
        if (n_in != 19 || in_sizes[0] != M * DM || out_size != M * DM || ws_size < WS_END) { fprintf(stderr, "kernel_launch: unexpected shapes (n_in %d, in0 %d, out %d, ws %zu); nothing launched\n", n_in, n_in > 0 ? in_sizes[0] : -1, out_size, ws_size); grid = -1; return; }
        int dev = 0, cus = 0, per_cu = 0;
        if (hipGetDevice(&dev) != hipSuccess || hipDeviceGetAttribute(&cus, hipDeviceAttributeMultiprocessorCount, dev) != hipSuccess) { fprintf(stderr, "kernel_launch: device query failed\n"); grid = -1; return; }
        if (hipFuncSetAttribute((const void*)fwd_kernel, hipFuncAttributeMaxDynamicSharedMemorySize, LDS_BYTES) != hipSuccess) { fprintf(stderr, "kernel_launch: hipFuncSetAttribute failed\n"); grid = -1; return; }
        if (hipOccupancyMaxActiveBlocksPerMultiprocessor(&per_cu, (const void*)fwd_kernel, NWAVES * 64, LDS_BYTES) != hipSuccess || per_cu < 1) { fprintf(stderr, "kernel_launch: occupancy query reports %d blocks per CU\n", per_cu); }
        (void)hipGetLastError();
        grid = cus;
    }
    if (grid < 0) return;
    if (hipMemsetAsync((char*)d_ws + WS_CTL, 0, CTL_ZERO_BYTES, stream) != hipSuccess) { fprintf(stderr, "kernel_launch: memset failed\n"); return; }
    Args a{};
    for (int i = 0; i < 19; ++i) a.in[i] = (const float*)d_in[i];
    a.out = (float*)d_out; a.ws = (unsigned char*)d_ws;
#if MK_PER_PHASE
    for (int p = 0; p < N_PHASES; ++p) { a.ph_lo = p; a.ph_hi = p + 1; hipLaunchKernelGGL(fwd_kernel, dim3(grid), dim3(NWAVES * 64), LDS_BYTES, stream, a); }
#else
    a.ph_lo = 0; a.ph_hi = N_PHASES;
    hipLaunchKernelGGL(fwd_kernel, dim3(grid), dim3(NWAVES * 64), LDS_BYTES, stream, a);
#endif
    const hipError_t le = hipPeekAtLastError();
    if (le != hipSuccess) fprintf(stderr, "kernel_launch: launch failed: %s\n", hipGetErrorName(le));
}
```
